# Optimizing an MI355X kernel written in HIP

```python
import jax, jax.numpy as jnp
from jax import lax
import numpy as np

D_MODEL = 2048
BATCH = 16
SEQ = 256
DEPTH = 2
DEC_BATCH = 4
DEC_SEQ = 2048
PAST_LEN = 512

GRID_W = 64
POOL_WIDTH = 512
POOL_GROUPS = 4
POOL_GROUP_DIM = POOL_WIDTH // POOL_GROUPS
POOL_WINDOWS = (2, 4, 8, 16)
ATTN_WIDTH = 512
N_HEADS = 4
V_DIM = ATTN_WIDTH // N_HEADS
QK_DIM = V_DIM // 2
ROPE_AXIS_DIM = QK_DIM // 2
ROPE_BASE = 10000.0
Q_BLOCK = 128
CONV_CH = 512
CONV_TAPS = 31
FOURIER_WIDTH = 512
FOURIER_HEADS = 4
FOURIER_HEAD_DIM = FOURIER_WIDTH // FOURIER_HEADS

MIX_WIDTH = POOL_WIDTH + ATTN_WIDTH + CONV_CH + FOURIER_WIDTH
IN_COLS = POOL_WIDTH + 3 * ATTN_WIDTH + 2 * CONV_CH + FOURIER_WIDTH
D_FF = ((8 * D_MODEL + 3 * 256 - 1) // (3 * 256)) * 256
EPS = 1e-6

kernel_name = "hybrid_diffusion_prefix_step"


def rmsnorm(x, g):
    xf = x.astype(jnp.float32)
    y = xf * lax.rsqrt(jnp.mean(xf * xf, axis=-1, keepdims=True) + EPS)
    return (y * g.astype(jnp.float32)).astype(x.dtype)


def layernorm(x, g, b):
    xf = x.astype(jnp.float32)
    mu = jnp.mean(xf, axis=-1, keepdims=True)
    xc = xf - mu
    y = xc * lax.rsqrt(jnp.mean(xc * xc, axis=-1, keepdims=True) + EPS)
    return (y * g.astype(jnp.float32) + b.astype(jnp.float32)).astype(x.dtype)


def axial_rope_tables(rows):
    t = jnp.arange(rows * GRID_W)
    row = (t // GRID_W).astype(jnp.float32)
    col = (t % GRID_W).astype(jnp.float32)
    inv = 1.0 / (ROPE_BASE ** (jnp.arange(0, ROPE_AXIS_DIM, 2, dtype=jnp.float32) / ROPE_AXIS_DIM))
    ar = row[:, None] * inv[None, :]
    ac = col[:, None] * inv[None, :]
    return (jnp.cos(ar), jnp.sin(ar), jnp.cos(ac), jnp.sin(ac))


def _rope_axis(x, cos, sin):
    half = ROPE_AXIS_DIM // 2
    cos = cos[None, :, None, None, :]
    sin = sin[None, :, None, None, :]
    x1, x2 = x[..., :half], x[..., half:]
    return jnp.concatenate([x1 * cos - x2 * sin, x2 * cos + x1 * sin], axis=-1)


def axial_rope(x, tabs):
    cr, sr, cc, sc = tabs
    xf = x.astype(jnp.float32)
    y = jnp.concatenate([_rope_axis(xf[..., :ROPE_AXIS_DIM], cr, sr),
                         _rope_axis(xf[..., ROPE_AXIS_DIM:], cc, sc)], axis=-1)
    return y.astype(x.dtype)


def multiscale_pool(u, pool_w, pool_scale):
    B, L, _ = u.shape
    uf = u.astype(jnp.float32)
    cs = jnp.concatenate([jnp.zeros((B, 1, POOL_WIDTH), jnp.float32), jnp.cumsum(uf, axis=1)], axis=1)
    t = jnp.arange(L)
    outs = []
    for g, w in enumerate(POOL_WINDOWS):
        sl = slice(g * POOL_GROUP_DIM, (g + 1) * POOL_GROUP_DIM)
        lo = jnp.maximum(t - w // 2, 0)
        hi = jnp.minimum(t + w // 2 - 1, L - 1)
        csg = cs[..., sl]
        s = jnp.take(csg, hi + 1, axis=1) - jnp.take(csg, lo, axis=1)
        cnt = (hi - lo + 1).astype(jnp.float32)[None, :, None]
        outs.append(s / cnt - uf[..., sl])
    p = jnp.stack(outs, axis=2).astype(u.dtype)
    y = jnp.einsum('blgc,gcd->blgd', p, pool_w).reshape(B, L, POOL_WIDTH)
    return y * pool_scale


def conformer_conv(u, dw, dw_b, ln_g, ln_b, pw, pw_b):
    a, b = jnp.split(u, 2, axis=-1)
    g = a * jax.nn.sigmoid(b)
    y = lax.conv_general_dilated(g, dw[:, None, :].astype(g.dtype), (1,),
                                 [(CONV_TAPS // 2, CONV_TAPS // 2)],
                                 dimension_numbers=('NWC', 'WIO', 'NWC'),
                                 feature_group_count=CONV_CH) + dw_b
    y = jax.nn.silu(layernorm(y, ln_g, ln_b))
    return y @ pw + pw_b


def fourier_mix(u, w):
    B, L, _ = u.shape
    uh = u.astype(jnp.float32).reshape(B, L, FOURIER_HEADS, FOURIER_HEAD_DIM)
    f = jnp.fft.fftn(uh, axes=(1, 3), norm='ortho').real
    return f.reshape(B, L, FOURIER_WIDTH).astype(u.dtype) @ w


def diff_attention(q, k, v, lam):
    B, Lq = q.shape[0], q.shape[1]
    nb = Lq // Q_BLOCK
    qb = jnp.moveaxis(q.reshape(B, nb, Q_BLOCK, N_HEADS, 2, QK_DIM), 1, 0)
    scale = QK_DIM ** -0.5

    def block(qi):
        s = jnp.einsum('bqhmd,bkhmd->bhmqk', qi, k, preferred_element_type=jnp.float32) * scale
        p = jax.nn.softmax(s, axis=-1)
        a = p[:, :, 0] - lam * p[:, :, 1]
        return jnp.einsum('bhqk,bkhd->bqhd', a.astype(v.dtype), v)

    o = lax.map(block, qb)
    return jnp.moveaxis(o, 0, 1).reshape(B, Lq, N_HEADS, V_DIM)


def token_mixer(h, lp, lam_init, rope, ctx_k, ctx_v):
    B, L, _ = h.shape
    z = h @ lp['w_in']
    o1 = POOL_WIDTH
    o2 = o1 + ATTN_WIDTH
    o3 = o2 + ATTN_WIDTH
    o4 = o3 + ATTN_WIDTH
    o5 = o4 + 2 * CONV_CH
    u_pool = z[..., :o1]
    q = rmsnorm(z[..., o1:o2].reshape(B, L, N_HEADS, 2, QK_DIM), lp['g_q'])
    k = rmsnorm(z[..., o2:o3].reshape(B, L, N_HEADS, 2, QK_DIM), lp['g_k'])
    v = z[..., o3:o4].reshape(B, L, N_HEADS, V_DIM)
    u_conv = z[..., o4:o5]
    u_four = z[..., o5:]

    if rope is None:
        keys, vals = k, v
    else:
        q = axial_rope(q, rope)
        keys = jnp.concatenate([axial_rope(k, rope), ctx_k.astype(k.dtype)], axis=1)
        vals = jnp.concatenate([v, ctx_v.astype(v.dtype)], axis=1)

    lv = lp['lam'].astype(jnp.float32)
    lam = jnp.exp(jnp.sum(lv[0] * lv[1])) - jnp.exp(jnp.sum(lv[2] * lv[3])) + lam_init
    att = diff_attention(q, keys, vals, lam)
    att = (rmsnorm(att, lp['g_subln']) * (1.0 - lam_init)).reshape(B, L, ATTN_WIDTH)

    y_pool = multiscale_pool(u_pool, lp['pool_w'], lp['pool_scale'])
    y_conv = conformer_conv(u_conv, lp['conv_dw'], lp['conv_dw_b'], lp['conv_ln_g'],
                            lp['conv_ln_b'], lp['conv_pw'], lp['conv_pw_b'])
    y_four = fourier_mix(u_four, lp['fourier_w'])
    y = jnp.concatenate([y_pool, att, y_conv, y_four], axis=-1) @ lp['w_out']
    return y, k, v


def trunk_layer(x, mod, lp, lam_init, rope, ctx_k, ctx_v):
    sh1, sc1, g1, sh2, sc2, g2 = jnp.split(mod, 6, axis=-1)
    h = rmsnorm(x, lp['g_norm1']) * (1.0 + sc1) + sh1
    a, k, v = token_mixer(h, lp, lam_init, rope, ctx_k, ctx_v)
    x = x + g1 * a
    h = rmsnorm(x, lp['g_norm2']) * (1.0 + sc2) + sh2
    f = (jax.nn.silu(h @ lp['w_gate']) * (h @ lp['w_up'])) @ lp['w_down']
    return x + g2 * f, k, v


def setup_inputs(seed: int = 0) -> dict:
    key = jax.random.key(seed)
    ks = jax.random.split(key, 32)
    f32 = jnp.float32

    def nrm(k, shape, scale=1.0):
        return jax.random.normal(k, shape, f32) * scale

    def gain(k, shape):
        return 1.0 + 0.05 * jax.random.normal(k, shape, f32)

    return {
        "x_prompt": nrm(ks[0], (BATCH, SEQ, D_MODEL)),
        "x_sample": nrm(ks[1], (DEC_BATCH, DEC_SEQ, D_MODEL)),
        "cache_k": nrm(ks[2], (DEC_BATCH, DEPTH, PAST_LEN, N_HEADS, 2, QK_DIM)),
        "cache_v": nrm(ks[3], (DEC_BATCH, DEPTH, PAST_LEN, N_HEADS, V_DIM)),
        "c": nrm(ks[4], (DEC_BATCH, D_MODEL)),
        "c_ctx": nrm(ks[5], (D_MODEL,)),
        "w_ada": nrm(ks[6], (DEPTH, D_MODEL, 6 * D_MODEL), 0.5 * D_MODEL ** -0.5),
        "b_ada": nrm(ks[7], (DEPTH, 6 * D_MODEL), 0.02),
        "g_norm1": gain(ks[8], (DEPTH, D_MODEL)),
        "w_in": nrm(ks[9], (DEPTH, D_MODEL, IN_COLS), D_MODEL ** -0.5),
        "pool_w": nrm(ks[10], (DEPTH, POOL_GROUPS, POOL_GROUP_DIM, POOL_GROUP_DIM), POOL_GROUP_DIM ** -0.5),
        "pool_scale": gain(ks[11], (DEPTH, POOL_WIDTH)),
        "g_q": gain(ks[12], (DEPTH, QK_DIM)),
        "g_k": gain(ks[13], (DEPTH, QK_DIM)),
        "lam": nrm(ks[14], (DEPTH, 4, QK_DIM), 0.1),
        "g_subln": gain(ks[15], (DEPTH, V_DIM)),
        "conv_dw": nrm(ks[16], (DEPTH, CONV_TAPS, CONV_CH), CONV_TAPS ** -0.5),
        "conv_dw_b": nrm(ks[17], (DEPTH, CONV_CH), 0.02),
        "conv_ln_g": gain(ks[18], (DEPTH, CONV_CH)),
        "conv_ln_b": nrm(ks[19], (DEPTH, CONV_CH), 0.02),
        "conv_pw": nrm(ks[20], (DEPTH, CONV_CH, CONV_CH), CONV_CH ** -0.5),
        "conv_pw_b": nrm(ks[21], (DEPTH, CONV_CH), 0.02),
        "fourier_w": nrm(ks[22], (DEPTH, FOURIER_WIDTH, FOURIER_WIDTH), FOURIER_WIDTH ** -0.5),
        "w_out": nrm(ks[23], (DEPTH, MIX_WIDTH, D_MODEL), MIX_WIDTH ** -0.5),
        "g_norm2": gain(ks[24], (DEPTH, D_MODEL)),
        "w_gate": nrm(ks[25], (DEPTH, D_MODEL, D_FF), D_MODEL ** -0.5),
        "w_up": nrm(ks[26], (DEPTH, D_MODEL, D_FF), D_MODEL ** -0.5),
        "w_down": nrm(ks[27], (DEPTH, D_FF, D_MODEL), D_FF ** -0.5),
    }


def reference(x_prompt, x_sample, cache_k, cache_v, c, c_ctx, w_ada, b_ada, g_norm1, w_in,
              pool_w, pool_scale, g_q, g_k, lam, g_subln, conv_dw, conv_dw_b, conv_ln_g,
              conv_ln_b, conv_pw, conv_pw_b, fourier_w, w_out, g_norm2, w_gate, w_up, w_down):
    rows = x_sample.shape[1] // GRID_W
    rope = axial_rope_tables(rows)
    yp, ys = x_prompt, x_sample
    new_k, new_v = [], []
    for l in range(DEPTH):
        lp = dict(w_in=w_in[l], pool_w=pool_w[l], pool_scale=pool_scale[l], g_q=g_q[l], g_k=g_k[l],
                  lam=lam[l], g_subln=g_subln[l], conv_dw=conv_dw[l], conv_dw_b=conv_dw_b[l],
                  conv_ln_g=conv_ln_g[l], conv_ln_b=conv_ln_b[l], conv_pw=conv_pw[l],
                  conv_pw_b=conv_pw_b[l], fourier_w=fourier_w[l], w_out=w_out[l],
                  g_norm1=g_norm1[l], g_norm2=g_norm2[l], w_gate=w_gate[l], w_up=w_up[l],
                  w_down=w_down[l])
        lam_init = 0.8 - 0.6 * float(np.exp(-0.3 * l))
        mod_ctx = (jax.nn.silu(c_ctx) @ w_ada[l] + b_ada[l])[None, None, :]
        mod_lat = (jax.nn.silu(c) @ w_ada[l] + b_ada[l])[:, None, :]
        yp, kc, vc = trunk_layer(yp, mod_ctx, lp, lam_init, None, None, None)
        new_k.append(kc)
        new_v.append(vc)
        ys, _, _ = trunk_layer(ys, mod_lat, lp, lam_init, rope, cache_k[:, l], cache_v[:, l])
    new_cache_k = jnp.stack(new_k, axis=1)
    new_cache_v = jnp.stack(new_v, axis=1)
    return (yp, ys, new_cache_k, new_cache_v)
```

```cpp
#define TEST_STAGE 0
#include <hip/hip_runtime.h>
#include <cstdio>
#include <cstdint>

#define LAS __attribute__((address_space(3)))
#define GAS __attribute__((address_space(1)))
#define DI __device__ __forceinline__
typedef unsigned short bf16_t;
typedef short bf16x8 __attribute__((ext_vector_type(8)));
typedef short s16x4 __attribute__((ext_vector_type(4)));
typedef float f32x2 __attribute__((ext_vector_type(2)));
typedef float f32x4 __attribute__((ext_vector_type(4)));
typedef float f32x16 __attribute__((ext_vector_type(16)));
typedef unsigned u32x2 __attribute__((ext_vector_type(2)));
typedef unsigned u32x4 __attribute__((ext_vector_type(4)));
typedef __bf16 bf16x2_t __attribute__((ext_vector_type(2)));

DI unsigned pk2(float lo, float hi) { f32x2 v = {lo, hi}; bf16x2_t b = __builtin_convertvector(v, bf16x2_t); return __builtin_bit_cast(unsigned, b); }
DI float bflo(unsigned w) { return __uint_as_float(w << 16); }
DI float bfhi(unsigned w) { return __uint_as_float(w & 0xffff0000u); }
DI float wave_sum(float v) {
#pragma unroll
    for (int o = 1; o < 64; o <<= 1) v += __shfl_xor(v, o);
    return v;
}
DI int opaque_tid() { int t = (int)threadIdx.x; asm volatile("" : "+v"(t)); return t; }
DI int uni(int v) { return __builtin_amdgcn_readfirstlane(v); }
DI long uni_l(long v) { const unsigned lo = (unsigned)__builtin_amdgcn_readfirstlane((int)(unsigned)(unsigned long)v), hi = (unsigned)__builtin_amdgcn_readfirstlane((int)(unsigned)((unsigned long)v >> 32)); return (long)(((unsigned long)hi << 32) | lo); }
DI const char* uni_p(const char* p) { return (const char*)uni_l((long)p); }
DI float fast_exp2(float x) { return __builtin_amdgcn_exp2f(x); }
DI float fast_rcp(float x) { return __builtin_amdgcn_rcpf(x); }
DI float silu_fast(float x) { return x * fast_rcp(1.f + fast_exp2(-1.4426950408889634f * x)); }
DI float sigmoid_fast(float x) { return fast_rcp(1.f + fast_exp2(-1.4426950408889634f * x)); }

constexpr int D = 2048, NCTX = 4096, NLAT = 8192, MT = 12288, INC = 3584, DFF = 5632;
constexpr int NKEY = NCTX + 4 * 2560;
constexpr float EPS = 1e-6f;
constexpr float QSCALE = 0.125f * 1.4426950408889634f;
DI int mod_vec(int row) { return row < NCTX ? 0 : 1 + ((row - NCTX) >> 11); }
DI int key_row(int row) { return row < NCTX ? row : NCTX + ((row - NCTX) >> 11) * 2560 + ((row - NCTX) & 2047); }

constexpr size_t MiB = 1u << 20;
constexpr size_t WS_CTL = 0, CTL_ZERO_BYTES = 64 * 1024;
constexpr size_t WS_MOD = 1 * MiB;
constexpr size_t WS_MISC = WS_MOD + 512 * 1024;
constexpr size_t WS_DC = 2 * MiB;
constexpr size_t WS_DL1 = WS_DC + 64 * 1024;
constexpr size_t WS_DL2 = 3 * MiB;
constexpr size_t WS_W = 20 * MiB;
constexpr size_t W_IN = 0, W_OUT = 14 * MiB, W_GU = 22 * MiB, W_DN = 66 * MiB, W_PL = 88 * MiB, W_CP = W_PL + 512 * 1024, W_FW = 89 * MiB, W_LAYER = 90 * MiB;
constexpr size_t WS_H = 200 * MiB, WS_UP = 248 * MiB, WS_QB = 260 * MiB, WS_KB = 272 * MiB, WS_VB = 300 * MiB, WS_UC = 328 * MiB, WS_UF = 352 * MiB;
constexpr size_t KV_LAYER = (size_t)NKEY * 512 * 2;
constexpr size_t WS_PP = 364 * MiB, WS_CS = 376 * MiB, WS_TT = 388 * MiB, WS_FF = 412 * MiB, WS_YMIX = 424 * MiB, WS_GU = 472 * MiB, WS_END = 604 * MiB;

namespace pg8 {
constexpr int BM = 256, BK = 64, HALF = 128, HTB = HALF * BK * 2, STAGE_BYTES = 8 * HTB, NXCD = 8, WGM = 8;
__host__ __device__ __forceinline__ int lds_byte(int r, int c) { const int st = (r >> 4) * 2 + (c >> 5), rr = r & 15, cc = c & 31, ob = rr * 64 + cc * 2; return st * 1024 + (ob ^ (((ob >> 9) & 1) << 5)); }
__host__ __device__ __forceinline__ void stage_rc(int b, int& R, int& C) { const int st = b / 1024, sb = b % 1024, swz = sb ^ (((sb >> 9) & 1) << 5); R = (st >> 1) * 16 + swz / 64; C = (st & 1) * 32 + (swz % 64) / 2; }
__host__ __device__ __forceinline__ int perm32(int rho) { const int n = rho >> 4, i = rho & 15; return 8 * (i >> 2) + 4 * n + (i & 3); }

struct Unit { int pm, pn; long coff; int ld1; long ld2; const char* a; const char* b; };
struct Gemm { int lda, ldb, K; };

template <class Epi, class Sched, bool ALIGN_EPI>
DI void gemm_phase(LAS unsigned char* lds, const Gemm g, const Sched& S, const Epi& E) {
    const int tid = opaque_tid(), wid = __builtin_amdgcn_readfirstlane(tid >> 6), lane = tid & 63, wr = wid >> 2, wc = wid & 3, fr = lane & 15, fq = lane >> 4;
    const int K = g.K, nt = K / BK;
    unsigned voffA[2], voffB[2];
#pragma unroll
    for (int i = 0; i < 2; ++i) { int R, C; stage_rc(tid * 16 + i * 8192, R, C); const int Rb = Epi::PERM ? ((R & ~31) + perm32(R & 31)) : R;
        voffA[i] = (unsigned)(R * g.lda + C) * 2u; voffB[i] = (unsigned)(Rb * g.ldb + C) * 2u; }
    const size_t kstep = (size_t)(BK * 2);
    const size_t hstepA = (size_t)HALF * g.lda * 2, hstepB = (size_t)HALF * g.ldb * 2;
    const unsigned ldsw = (unsigned)wid * 1024u;
    const int aoff = lds_byte(wr * 64 + fr, fq * 8), boff = lds_byte(wc * 32 + fr, fq * 8);
#define PG8_SA(b, h) (((b) * 2 + (h)) * HTB)
#define PG8_SB(b, h) ((4 + (b) * 2 + (h)) * HTB)
#define PG8_STAGE(bufoff, gbase, voff) do { _Pragma("unroll") for (int _i = 0; _i < 2; ++_i) \
        __builtin_amdgcn_global_load_lds((const unsigned*)((const char*)(gbase) + (voff)[_i]), (LAS unsigned*)(lds + (bufoff) + ldsw + _i * 8192), 16, 0, 0); } while (0)
#define PG8_LDA(dst, b, h) do { _Pragma("unroll") for (int m = 0; m < 4; ++m) _Pragma("unroll") for (int k = 0; k < 2; ++k) dst[m][k] = *(const LAS bf16x8*)(lds + PG8_SA(b, h) + aoff + m * 2048 + k * 1024); } while (0)
#define PG8_LDB(dst, b, h) do { _Pragma("unroll") for (int n = 0; n < 2; ++n) _Pragma("unroll") for (int k = 0; k < 2; ++k) dst[n][k] = *(const LAS bf16x8*)(lds + PG8_SB(b, h) + boff + n * 2048 + k * 1024); } while (0)
#define PG8_MMA(ai, bj, At, Bt) do { __builtin_amdgcn_s_setprio(1); _Pragma("unroll") for (int m = 0; m < 4; ++m) _Pragma("unroll") for (int n = 0; n < 2; ++n) _Pragma("unroll") for (int k = 0; k < 2; ++k) \
        acc[ai][bj][m][n] = __builtin_amdgcn_mfma_f32_16x16x32_bf16(Bt[n][k], At[m][k], acc[ai][bj][m][n], 0, 0, 0); __builtin_amdgcn_s_setprio(0); } while (0)
#define PG8_WAIT_V(n) asm volatile("s_waitcnt vmcnt(" #n ")" ::: "memory")
#define PG8_WAIT_L(n) asm volatile("s_waitcnt lgkmcnt(" #n ")" ::: "memory")
#define PG8_BAR __builtin_amdgcn_s_barrier()
#define PG8_SCHED __builtin_amdgcn_sched_barrier(0)
    Unit cur, nxt; int ui = 0;
    if (!S.next(0, cur)) return;
    f32x4 acc[2][2][4][2];
#pragma unroll
    for (int a = 0; a < 2; ++a)
#pragma unroll
        for (int b = 0; b < 2; ++b)
#pragma unroll
            for (int m = 0; m < 4; ++m)
#pragma unroll
                for (int n = 0; n < 2; ++n) acc[a][b][m][n] = (f32x4){0.f, 0.f, 0.f, 0.f};
    bf16x8 At[4][2], B0[2][2], B1[2][2];
    const char* cA = cur.a; const char* cB = cur.b;
    PG8_STAGE(PG8_SB(0, 0), cB, voffB); PG8_STAGE(PG8_SB(0, 1), cB + hstepB, voffB); PG8_STAGE(PG8_SA(0, 0), cA, voffA); PG8_STAGE(PG8_SA(0, 1), cA + hstepA, voffA);
    if (wr == 1) PG8_BAR;
    PG8_WAIT_V(2); PG8_BAR;
    PG8_STAGE(PG8_SB(1, 0), cB + kstep, voffB); PG8_STAGE(PG8_SA(1, 0), cA + kstep, voffA); PG8_STAGE(PG8_SB(1, 1), cB + hstepB + kstep, voffB);
    PG8_WAIT_V(6); PG8_BAR;
    for (;;) {
        const bool has_next = S.next(ui + 1, nxt);
        const char* nA = has_next ? nxt.a : cA; const char* nB = has_next ? nxt.b : cB;
        for (int t = 0; t < nt; t += 2) {
            const bool last = (t == nt - 2);
            const char* a1 = cA + (size_t)(t + 1) * kstep;
            const char* a2 = last ? nA : cA + (size_t)(t + 2) * kstep; const char* b2 = last ? nB : cB + (size_t)(t + 2) * kstep;
            const char* a3 = a2 + kstep; const char* b3 = b2 + kstep;
            PG8_LDB(B0, 0, 0); PG8_LDB(B1, 0, 1); PG8_SCHED; PG8_LDA(At, 0, 0); PG8_STAGE(PG8_SA(1, 1), a1 + hstepA, voffA);
            PG8_WAIT_V(8); PG8_WAIT_L(0); PG8_BAR; PG8_MMA(0, 0, At, B0); PG8_MMA(0, 1, At, B1); PG8_BAR; PG8_SCHED;
            PG8_LDA(At, 0, 1); PG8_STAGE(PG8_SB(0, 0), b2, voffB); PG8_STAGE(PG8_SB(0, 1), b2 + hstepB, voffB); PG8_STAGE(PG8_SA(0, 0), a2, voffA);
            PG8_WAIT_V(8); PG8_WAIT_L(0); PG8_BAR; PG8_MMA(1, 0, At, B0); PG8_MMA(1, 1, At, B1); PG8_BAR; PG8_SCHED;
            PG8_LDB(B0, 1, 0); PG8_LDB(B1, 1, 1); PG8_SCHED; PG8_LDA(At, 1, 0); PG8_STAGE(PG8_SA(0, 1), a2 + hstepA, voffA);
            PG8_WAIT_V(8); PG8_WAIT_L(0); PG8_BAR; PG8_MMA(0, 0, At, B0); PG8_MMA(0, 1, At, B1); PG8_BAR; PG8_SCHED;
            PG8_LDA(At, 1, 1); PG8_STAGE(PG8_SB(1, 0), b3, voffB); PG8_STAGE(PG8_SB(1, 1), b3 + hstepB, voffB); PG8_STAGE(PG8_SA(1, 0), a3, voffA);
            PG8_WAIT_V(8); PG8_WAIT_L(0); PG8_BAR; PG8_MMA(1, 0, At, B0); PG8_MMA(1, 1, At, B1); PG8_BAR; PG8_SCHED;
        }
        if constexpr (ALIGN_EPI) { if (wr == 0) PG8_BAR; }
        E(acc, cur, wr, wc, fr, fq);
        if (!has_next) break;
#pragma unroll
        for (int a = 0; a < 2; ++a)
#pragma unroll
            for (int b = 0; b < 2; ++b)
#pragma unroll
                for (int m = 0; m < 4; ++m)
#pragma unroll
                    for (int n = 0; n < 2; ++n) acc[a][b][m][n] = (f32x4){0.f, 0.f, 0.f, 0.f};
        cur = nxt; cA = nA; cB = nB; ++ui;
        if constexpr (ALIGN_EPI) { if (wr == 1) PG8_BAR; }
    }
    PG8_WAIT_V(0);
    if constexpr (!ALIGN_EPI) { if (wr == 0) PG8_BAR; }
    PG8_BAR;
#undef PG8_SA
#undef PG8_SB
#undef PG8_STAGE
#undef PG8_LDA
#undef PG8_LDB
#undef PG8_MMA
#undef PG8_WAIT_V
#undef PG8_WAIT_L
#undef PG8_BAR
#undef PG8_SCHED
}

struct StaticOrder {
    int nM, nN, nwg, G, c; const char* A; const char* B; size_t tA, tB; long ldc;
    DI void init(int M, int N, int G_, int c_, const void* A_, int lda, const void* B_, int ldb, long ldc_) {
        nM = M / BM; nN = N / BM; nwg = nM * nN; G = G_; c = c_; A = (const char*)A_; B = (const char*)B_; tA = (size_t)BM * lda * 2; tB = (size_t)BM * ldb * 2; ldc = ldc_; }
    DI bool next(int i, Unit& u) const {
        const long L = (long)i * G + c; if (L >= nwg) return false;
        int wgid = (int)L; { const int q = nwg / NXCD, r = nwg % NXCD, xcd = wgid % NXCD, off = wgid / NXCD; wgid = (xcd < r ? xcd * (q + 1) : r * (q + 1) + (xcd - r) * q) + off; }
        const int nig = WGM * nN, gid = wgid / nig, fm = gid * WGM, gsz = (nM - fm) < WGM ? (nM - fm) : WGM;
        u.pm = fm + ((wgid % nig) % gsz); u.pn = (wgid % nig) / gsz;
        u.pm = uni(u.pm); u.pn = uni(u.pn);
        u.a = uni_p(A + (size_t)u.pm * tA); u.b = uni_p(B + (size_t)u.pn * tB); u.coff = uni_l((long)u.pm * BM * ldc + (long)u.pn * BM); u.ld1 = (int)ldc; u.ld2 = 128 * ldc; return true;
    }
};
}
namespace pg8 {
struct EpiStore {
    static constexpr bool PERM = true;
    bf16_t* dst; const float* cscale; const float* cbias; float alpha;
    DI void operator()(const f32x4 (&acc)[2][2][4][2], const Unit& u, int wr, int wc, int fr, int fq) const {
        const int c0 = wc * 32 + 8 * fq;
        const bool has_s = cscale != nullptr, has_b = cbias != nullptr;
        const float* sp = (has_s ? cscale : cbias) + u.pn * BM + c0;
        const float* bp = (has_b ? cbias : cscale) + u.pn * BM + c0;
        bf16_t* base = dst + u.coff + (long)(wr * 64 + fr) * u.ld1 + c0;
#pragma unroll
        for (int bj = 0; bj < 2; ++bj) {
            f32x4 s0 = (f32x4){1.f, 1.f, 1.f, 1.f}, s1 = s0, b0 = (f32x4){0.f, 0.f, 0.f, 0.f}, b1 = b0;
            if (has_s) { s0 = *(const f32x4*)(sp + bj * HALF); s1 = *(const f32x4*)(sp + bj * HALF + 4); }
            if (has_b) { b0 = *(const f32x4*)(bp + bj * HALF); b1 = *(const f32x4*)(bp + bj * HALF + 4); }
#pragma unroll
            for (int ai = 0; ai < 2; ++ai)
#pragma unroll
                for (int m = 0; m < 4; ++m) {
                    const f32x4 v0 = (acc[ai][bj][m][0] * alpha + b0) * s0, v1 = (acc[ai][bj][m][1] * alpha + b1) * s1;
                    u32x4 w; w.x = pk2(v0[0], v0[1]); w.y = pk2(v0[2], v0[3]); w.z = pk2(v1[0], v1[1]); w.w = pk2(v1[2], v1[3]);
                    *(u32x4*)(base + (long)ai * u.ld2 + (long)(m * 16) * u.ld1 + bj * HALF) = w;
                }
        }
    }
};

struct EpiResid {
    static constexpr bool PERM = false;
    const float* xin_ctx; const float* xin_lat; float* out; const float* gate;
    DI void operator()(const f32x4 (&acc)[2][2][4][2], const Unit& u, int wr, int wc, int fr, int fq) const {
        const int row0 = u.pm * BM + wr * 64 + fr, col0 = u.pn * BM + wc * 32 + 4 * fq;
        const bool ctx = (u.pm * BM) < NCTX;
        const float* gv = gate + (size_t)mod_vec(u.pm * BM) * 12288 + col0;
        f32x4 gt[2][2];
#pragma unroll
        for (int bj = 0; bj < 2; ++bj)
#pragma unroll
            for (int n = 0; n < 2; ++n) gt[bj][n] = *(const f32x4*)(gv + bj * HALF + n * 16);
#pragma unroll
        for (int ai = 0; ai < 2; ++ai)
#pragma unroll
            for (int m = 0; m < 4; ++m) {
                const int row = row0 + ai * HALF + m * 16;
                const float* xi = ctx ? (xin_ctx + (size_t)row * D) : (xin_lat + (size_t)(row - NCTX) * D);
                float* op = out + (size_t)row * D + col0;
#pragma unroll
                for (int bj = 0; bj < 2; ++bj)
#pragma unroll
                    for (int n = 0; n < 2; ++n) {
                        const f32x4 xv = *(const f32x4*)(xi + col0 + bj * HALF + n * 16);
                        *(f32x4*)(op + bj * HALF + n * 16) = xv + gt[bj][n] * acc[ai][bj][m][n];
                    }
            }
    }
};

struct EpiSwiglu {
    static constexpr bool PERM = true;
    bf16_t* gu;
    DI void operator()(const f32x4 (&acc)[2][2][4][2], const Unit& u, int wr, int wc, int fr, int fq) const {
        const int row0 = u.pm * BM + wr * 64 + fr, col0 = u.pn * HALF + wc * 32 + 8 * fq;
#pragma unroll
        for (int ai = 0; ai < 2; ++ai)
#pragma unroll
            for (int m = 0; m < 4; ++m) {
                const f32x4 g0 = acc[ai][0][m][0], g1 = acc[ai][0][m][1], u0 = acc[ai][1][m][0], u1 = acc[ai][1][m][1];
                u32x4 w;
                w.x = pk2(silu_fast(g0[0]) * u0[0], silu_fast(g0[1]) * u0[1]); w.y = pk2(silu_fast(g0[2]) * u0[2], silu_fast(g0[3]) * u0[3]);
                w.z = pk2(silu_fast(g1[0]) * u1[0], silu_fast(g1[1]) * u1[1]); w.w = pk2(silu_fast(g1[2]) * u1[2], silu_fast(g1[3]) * u1[3]);
                *(u32x4*)(gu + (size_t)(row0 + ai * HALF + m * 16) * DFF + col0) = w;
            }
    }
};

struct EpiG1 {
    static constexpr bool PERM = false;
    bf16_t *up, *qb, *kb, *vb, *uc, *uf;
    float *nck, *ncv;
    const float *gq, *gk, *tabc, *tabs; int layer;
    DI void operator()(const f32x4 (&acc)[2][2][4][2], const Unit& u, int wr, int wc, int fr, int fq) const {
        const int pn = u.pn, rowt = u.pm * BM, r0 = wr * 64 + fr;
        const bool ctx = rowt < NCTX;
        const int acb = 64 * wc + 4 * fq;
        if (pn < 2 || pn >= 8) {
            bf16_t* base; int ld, cs;
            if (pn < 2) { base = up; ld = 512; cs = pn * 256; } else if (pn < 12) { base = uc; ld = 1024; cs = (pn - 8) * 256; } else { base = uf; ld = 512; cs = (pn - 12) * 256; }
#pragma unroll
            for (int ai = 0; ai < 2; ++ai)
#pragma unroll
                for (int m = 0; m < 4; ++m) {
                    bf16_t* rp = base + (size_t)(rowt + ai * HALF + m * 16 + r0) * ld + cs + acb;
#pragma unroll
                    for (int bj = 0; bj < 2; ++bj)
#pragma unroll
                        for (int n = 0; n < 2; ++n) { const f32x4 v = acc[ai][bj][m][n]; u32x2 w; w.x = pk2(v[0], v[1]); w.y = pk2(v[2], v[3]); *(u32x2*)(rp + 32 * bj + 16 * n) = w; }
                }
        } else if (pn >= 6) {
            const int cs = (pn - 6) * 256;
#pragma unroll
            for (int ai = 0; ai < 2; ++ai)
#pragma unroll
                for (int m = 0; m < 4; ++m) {
                    const int row = rowt + ai * HALF + m * 16 + r0;
                    bf16_t* rp = vb + (size_t)key_row(row) * 512 + cs + acb;
                    float* fp = ncv + ((size_t)((row >> 8) * 2 + layer) * 256 + (row & 255)) * 512 + cs + acb;
#pragma unroll
                    for (int bj = 0; bj < 2; ++bj)
#pragma unroll
                        for (int n = 0; n < 2; ++n) { const f32x4 v = acc[ai][bj][m][n]; u32x2 w; w.x = pk2(v[0], v[1]); w.y = pk2(v[2], v[3]); *(u32x2*)(rp + 32 * bj + 16 * n) = w;
                            if (ctx) *(f32x4*)(fp + 32 * bj + 16 * n) = v; }
                }
        } else {
            const bool isq = pn < 4; const int cs = (pn - (isq ? 2 : 4)) * 256;
            const float* gg = isq ? gq : gk;
            f32x4 gn[2][2];
#pragma unroll
            for (int bj = 0; bj < 2; ++bj)
#pragma unroll
                for (int n = 0; n < 2; ++n) gn[bj][n] = *(const f32x4*)(gg + 32 * bj + 16 * n + 4 * fq);
#pragma unroll
            for (int ai = 0; ai < 2; ++ai)
#pragma unroll
                for (int m = 0; m < 4; ++m) {
                    const int row = rowt + ai * HALF + m * 16 + r0;
                    f32x4 v[2][2]; float ss = 0.f;
#pragma unroll
                    for (int bj = 0; bj < 2; ++bj)
#pragma unroll
                        for (int n = 0; n < 2; ++n) { v[bj][n] = acc[ai][bj][m][n]; const f32x4 q = v[bj][n] * v[bj][n]; ss += (q[0] + q[1]) + (q[2] + q[3]); }
                    ss += __shfl_xor(ss, 16); ss += __shfl_xor(ss, 32);
                    const float rn = __builtin_amdgcn_rsqf(ss * (1.f / 64.f) + EPS);
#pragma unroll
                    for (int bj = 0; bj < 2; ++bj)
#pragma unroll
                        for (int n = 0; n < 2; ++n) v[bj][n] = v[bj][n] * rn * gn[bj][n];
                    if (!isq && ctx) {
                        float* fp = nck + ((size_t)((row >> 8) * 2 + layer) * 256 + (row & 255)) * 512 + cs + acb;
#pragma unroll
                        for (int bj = 0; bj < 2; ++bj)
#pragma unroll
                            for (int n = 0; n < 2; ++n) *(f32x4*)(fp + 32 * bj + 16 * n) = v[bj][n];
                    }
                    if (!ctx) {
                        const int t = (row - NCTX) & 2047;
#pragma unroll
                        for (int bj = 0; bj < 2; ++bj) {
                            const int pos = bj == 0 ? (t >> 6) : (t & 63);
                            const f32x4 c = *(const f32x4*)(tabc + pos * 16 + 4 * fq), s = *(const f32x4*)(tabs + pos * 16 + 4 * fq);
                            const f32x4 x1 = v[bj][0], x2 = v[bj][1];
                            v[bj][0] = x1 * c - x2 * s; v[bj][1] = x2 * c + x1 * s;
                        }
                    }
                    bf16_t* rp = isq ? (qb + (size_t)row * 512 + cs + acb) : (kb + (size_t)key_row(row) * 512 + cs + acb);
                    const float osc = isq ? QSCALE : 1.f;
#pragma unroll
                    for (int bj = 0; bj < 2; ++bj)
#pragma unroll
                        for (int n = 0; n < 2; ++n) { const f32x4 o = v[bj][n] * osc; u32x2 w; w.x = pk2(o[0], o[1]); w.y = pk2(o[2], o[3]); *(u32x2*)(rp + 32 * bj + 16 * n) = w; }
                }
        }
    }
};
}
#define XB_TMO      128
#define XB_XCNT(j)  (256  + 64 * (j))
#define XB_XSUB(j)  (1280 + 64 * (j))
#define XB_XGEN(j)  (2304 + 64 * (j))
#define XB_TOP      3328
#define XB_TOPGEN   3392
#define XCD_BAR_WORDS 3456
#define XB_SPIN_CAP (1u << 18)
DI unsigned xb_ld(unsigned* p)              { return __hip_atomic_load(p, __ATOMIC_RELAXED, __HIP_MEMORY_SCOPE_AGENT); }
DI unsigned xb_add(unsigned* p, unsigned v) { return __hip_atomic_fetch_add(p, v, __ATOMIC_RELAXED, __HIP_MEMORY_SCOPE_AGENT); }
DI unsigned xb_xcc_id() { return (unsigned)__builtin_amdgcn_s_getreg((3 << 11) | 20) & 0xFu; }
#define XB_SPIN(cond, bar) do { unsigned _sp = 0; while (cond) { __builtin_amdgcn_s_sleep(1); \
    if ((++_sp & 255u) == 0u) { if (xb_ld(&(bar)[XB_TMO])) break; if (_sp > XB_SPIN_CAP) { atomicAdd(&(bar)[XB_TMO], 1u); break; } } } } while (0)
struct XcdBarrier { unsigned* bar; unsigned x; volatile LAS unsigned* st; };
DI XcdBarrier xcd_barrier_post(unsigned* bar, volatile LAS unsigned* st) {
    XcdBarrier b; b.bar = bar; b.x = xb_xcc_id(); b.st = st;
    if (threadIdx.x == 0) (void)xb_add(&bar[XB_XCNT(b.x)], 1u);
    return b;
}
DI void xcd_barrier_complete(unsigned* bar, unsigned x, unsigned& nloc, unsigned& nx) {
    const unsigned G = gridDim.x * gridDim.y * gridDim.z;
    unsigned sum, cnt, mine, sp = 0u;
    for (;;) {
        sum = 0u; cnt = 0u; mine = 0u;
#pragma unroll
        for (unsigned j = 0; j < 16; ++j) { const unsigned c = xb_ld(&bar[XB_XCNT(j)]); sum += c; cnt += (c > 0u) ? 1u : 0u; mine = (j == x) ? c : mine; }
        if (sum == G) break;
        __builtin_amdgcn_s_sleep(1);
        if ((++sp & 255u) == 0u) { if (xb_ld(&bar[XB_TMO])) break; if (sp > XB_SPIN_CAP) { atomicAdd(&bar[XB_TMO], 1u); break; } }
    }
    nloc = mine > 0u ? mine : 1u; nx = cnt > 0u ? cnt : 1u;
}
DI void xcd_barrier(const XcdBarrier& b) {
    asm volatile("s_waitcnt vmcnt(0)" ::: "memory");
    __syncthreads();
    if (threadIdx.x == 0) {
        unsigned* bar = b.bar;
        __builtin_amdgcn_s_waitcnt(0);
        unsigned nloc = b.st[0], nx = b.st[1];
        if (nloc == 0u) { xcd_barrier_complete(bar, b.x, nloc, nx); b.st[0] = nloc; b.st[1] = nx; }
        const unsigned old = xb_add(&bar[XB_XSUB(b.x)], 1u);
        const unsigned gen = old / nloc;
        if (old + 1u == (gen + 1u) * nloc) {
            __builtin_amdgcn_fence(__ATOMIC_RELEASE, "agent");
            asm volatile("s_waitcnt vmcnt(0)" ::: "memory");
            const unsigned og = xb_add(&bar[XB_TOP], 1u);
            const unsigned tg = og / nx;
            if (og + 1u == (tg + 1u) * nx) xb_add(&bar[XB_TOPGEN], 1u);
            else XB_SPIN(xb_ld(&bar[XB_TOPGEN]) == tg, bar);
            __builtin_amdgcn_fence(__ATOMIC_ACQUIRE, "agent");
            xb_add(&bar[XB_XGEN(b.x)], 1u);
            asm volatile("s_waitcnt vmcnt(0)" ::: "memory");
        } else {
            XB_SPIN(xb_ld(&bar[XB_XGEN(b.x)]) == gen, bar);
            __builtin_amdgcn_fence(__ATOMIC_ACQUIRE, "agent");
            asm volatile("s_waitcnt vmcnt(0)" ::: "memory");
        }
    }
    __syncthreads();
}
struct Args { const float* in[28]; float* out; unsigned char* ws; int ph_lo, ph_hi; };
struct Ctx { LAS unsigned char* lds; int tid, lane, wave, vcu, G; };
constexpr int RING_BYTES = 131072, MISC_OFF = RING_BYTES + 320, LDS_BYTES = 147456;

enum { MAP_ID = 0, MAP_WIN = 1, MAP_GATE = 2, MAP_UP = 3 };
DI int map_row(int kind, int n) {
    if (kind == MAP_WIN) { const int ac = n & 255; return (n & ~255) + 128 * ((ac >> 5) & 1) + 32 * (ac >> 6) + (ac & 31); }
    if (kind == MAP_GATE) return 256 * (n >> 7) + (n & 127);
    if (kind == MAP_UP) return 256 * (n >> 7) + 128 + (n & 127);
    return n;
}
DI void p0_transpose_item(const float* W, int N, bf16_t* dst, int ldd, int kind, LAS float* scr, int item, int lane) {
    const int nblk = N / 32, kb = item / nblk, nb = item % nblk, k0 = 64 * kb, n0 = 32 * nb;
#pragma unroll 8
    for (int i = 0; i < 32; ++i) { const int kk = 2 * i + (lane >> 5); scr[kk * 33 + (lane & 31)] = W[(size_t)(k0 + kk) * N + n0 + (lane & 31)]; }
    asm volatile("s_waitcnt lgkmcnt(0)" ::: "memory");
    const int c = lane & 7, r0 = map_row(kind, n0);
#pragma unroll
    for (int j = 0; j < 4; ++j) { const int n = (lane >> 3) + 8 * j; const LAS float* s = scr + (8 * c) * 33 + n;
        u32x4 o; o.x = pk2(s[0 * 33], s[1 * 33]); o.y = pk2(s[2 * 33], s[3 * 33]); o.z = pk2(s[4 * 33], s[5 * 33]); o.w = pk2(s[6 * 33], s[7 * 33]);
        *(u32x4*)(dst + (size_t)(r0 + n) * ldd + k0 + 8 * c) = o; }
    asm volatile("s_waitcnt lgkmcnt(0)" ::: "memory");
}

DI void phase_p0(const Args& a, const Ctx& c0_) {
    Ctx c = c0_; c.tid = opaque_tid(); c.lane = c.tid & 63; c.wave = __builtin_amdgcn_readfirstlane(c.tid >> 6);
    float* mod = (float*)(a.ws + WS_MOD);
    float* misc = (float*)(a.ws + WS_MISC);
    {
        LAS float* sv = (LAS float*)c.lds;
        LAS float* red = sv + 5 * 2048;
        for (int i = c.tid; i < 5 * 2048; i += 512) { const int v = i >> 11, k = i & 2047; const float x = v == 0 ? a.in[5][k] : a.in[4][(v - 1) * 2048 + k]; sv[i] = x / (1.f + expf(-x)); }
        __syncthreads();
        for (int u = c.vcu; u < 768; u += c.G) {
            const int l = u / 384, c0 = (u % 384) * 32, kg = c.tid >> 3, cl = 4 * (c.tid & 7);
            const float* W = a.in[6] + (size_t)l * 2048 * 12288 + c0 + cl;
            f32x4 acc[5];
#pragma unroll
            for (int v = 0; v < 5; ++v) acc[v] = (f32x4){0.f, 0.f, 0.f, 0.f};
#pragma unroll 8
            for (int kk = 0; kk < 32; ++kk) { const int k = kg * 32 + kk; const f32x4 w = *(const f32x4*)(W + (size_t)k * 12288);
#pragma unroll
                for (int v = 0; v < 5; ++v) acc[v] += w * sv[v * 2048 + k]; }
#pragma unroll
            for (int v = 0; v < 5; ++v) *(LAS f32x4*)(red + (kg * 5 + v) * 32 + cl) = acc[v];
            __syncthreads();
            if (c.tid < 160) { const int v = c.tid >> 5, col = c.tid & 31; float s = 0.f;
                for (int g = 0; g < 64; ++g) s += red[(g * 5 + v) * 32 + col];
                mod[(size_t)(l * 5 + v) * 12288 + c0 + col] = s + a.in[7][l * 12288 + c0 + col]; }
            __syncthreads();
        }
    }
    {
        LAS float* scr = (LAS float*)(c.lds + c.wave * 16384);
        const int gw = c.vcu * 8 + c.wave, NGW = c.G * 8;
        constexpr int I_IN = 32 * 112, I_OUT = 32 * 64, I_G = 32 * 176, I_DN = 88 * 64, I_S = 8 * 16, I_P = 2 * 4;
        constexpr int PER_LAYER = I_IN + I_OUT + 2 * I_G + I_DN + 2 * I_S + 4 * I_P;
        for (int it = gw; it < 2 * PER_LAYER; it += NGW) {
            const int l = it / PER_LAYER; int r = it % PER_LAYER;
            unsigned char* wl = a.ws + WS_W + (size_t)l * W_LAYER;
            if (r < I_IN) { p0_transpose_item(a.in[9] + (size_t)l * D * INC, INC, (bf16_t*)(wl + W_IN), D, MAP_WIN, scr, r, c.lane); continue; } r -= I_IN;
            if (r < I_OUT) { p0_transpose_item(a.in[23] + (size_t)l * D * D, D, (bf16_t*)(wl + W_OUT), D, MAP_ID, scr, r, c.lane); continue; } r -= I_OUT;
            if (r < I_G) { p0_transpose_item(a.in[25] + (size_t)l * D * DFF, DFF, (bf16_t*)(wl + W_GU), D, MAP_GATE, scr, r, c.lane); continue; } r -= I_G;
            if (r < I_G) { p0_transpose_item(a.in[26] + (size_t)l * D * DFF, DFF, (bf16_t*)(wl + W_GU), D, MAP_UP, scr, r, c.lane); continue; } r -= I_G;
            if (r < I_DN) { p0_transpose_item(a.in[27] + (size_t)l * DFF * D, D, (bf16_t*)(wl + W_DN), DFF, MAP_ID, scr, r, c.lane); continue; } r -= I_DN;
            if (r < I_S) { p0_transpose_item(a.in[20] + (size_t)l * 512 * 512, 512, (bf16_t*)(wl + W_CP), 512, MAP_ID, scr, r, c.lane); continue; } r -= I_S;
            if (r < I_S) { p0_transpose_item(a.in[22] + (size_t)l * 512 * 512, 512, (bf16_t*)(wl + W_FW), 512, MAP_ID, scr, r, c.lane); continue; } r -= I_S;
            { const int g = r / I_P; r %= I_P;
              p0_transpose_item(a.in[10] + (size_t)(l * 4 + g) * 128 * 128, 128, (bf16_t*)(wl + W_PL) + (size_t)(g * 128) * 512 + g * 128, 512, MAP_ID, scr, r, c.lane); }
        }
    }
    {
        const int gt = c.vcu * 512 + c.tid, NT = c.G * 512;
        for (int i = gt; i < 2 * 12 * 128 * 16; i += NT) { const int l = i / (12 * 2048), r = i % (12 * 2048), blk = r / 2048, rr = (r % 2048) / 16, ch = r % 16;
            const int g = blk / 3, gp0 = blk % 3, gp = gp0 + (gp0 >= g ? 1 : 0);
            *(u32x4*)((bf16_t*)(a.ws + WS_W + (size_t)l * W_LAYER + W_PL) + (size_t)(g * 128 + rr) * 512 + gp * 128 + ch * 8) = (u32x4){0u, 0u, 0u, 0u}; }
        for (int i = gt; i < 2048 * 512; i += NT) { const int k = i >> 9, cg = i & 511; unsigned w[4];
#pragma unroll
            for (int e = 0; e < 4; ++e) { float f[2];
#pragma unroll
                for (int h = 0; h < 2; ++h) { const int col = cg * 8 + 2 * e + h, ll = col & 2047; const float x = (float)((k * ll) & 2047) * (1.0f / 1024.0f);
                    f[h] = col < 2048 ? cospif(x) : -sinpif(x); }
                w[e] = pk2(f[0], f[1]); }
            *(u32x4*)((bf16_t*)(a.ws + WS_DL2) + (size_t)k * 4096 + cg * 8) = (u32x4){w[0], w[1], w[2], w[3]}; }
        for (int i = gt; i < 256 * 64; i += NT) { const int k = i >> 6, cg = i & 63; unsigned w[4];
#pragma unroll
            for (int e = 0; e < 4; ++e) { float f[2];
#pragma unroll
                for (int h = 0; h < 2; ++h) { const int col = cg * 8 + 2 * e + h, ll = col & 255; const float x = (float)((k * ll) & 255) * (1.0f / 128.0f);
                    f[h] = col < 256 ? cospif(x) : -sinpif(x); }
                w[e] = pk2(f[0], f[1]); }
            *(u32x4*)((bf16_t*)(a.ws + WS_DL1) + (size_t)k * 512 + cg * 8) = (u32x4){w[0], w[1], w[2], w[3]}; }
        for (int i = gt; i < 256 * 16; i += NT) { const int rr = i >> 4, cg = i & 15, m = rr & 127; unsigned w[4];
#pragma unroll
            for (int e = 0; e < 4; ++e) { float f[2];
#pragma unroll
                for (int h = 0; h < 2; ++h) { const int cc = cg * 8 + 2 * e + h; const float x = (float)((m * cc) & 127) * (1.0f / 64.0f); f[h] = rr < 128 ? cospif(x) : sinpif(x); }
                w[e] = pk2(f[0], f[1]); }
            *(u32x4*)((bf16_t*)(a.ws + WS_DC) + (size_t)rr * 128 + cg * 8) = (u32x4){w[0], w[1], w[2], w[3]}; }
        if (gt < 1024) { const int pos = gt >> 4, i = gt & 15; const float inv = 1.0f / powf(10000.0f, (float)(2 * i) / 32.0f); const float ang = (float)pos * inv;
            misc[64 + gt] = cosf(ang); misc[64 + 1024 + gt] = sinf(ang); }
        if (c.vcu == 1 && c.wave < 2) { const int l = c.wave; const float* lv = a.in[14] + l * 256;
            const float s1 = wave_sum(lv[c.lane] * lv[64 + c.lane]), s2 = wave_sum(lv[128 + c.lane] * lv[192 + c.lane]);
            if (c.lane == 0) misc[l] = expf(s1) - expf(s2) + (0.8f - 0.6f * expf(-0.3f * (float)l)); }
        for (int i = gt; i < 2 * 4 * 2 * 512 * 64; i += NT) { const int kv = i / (4 * 2 * 512 * 64), r = i % (4 * 2 * 512 * 64), b = r / (2 * 512 * 64), l = (r / (512 * 64)) & 1, j = (r >> 6) & 511, ch = r & 63;
            const float* src = a.in[kv ? 3 : 2] + ((size_t)((b * 2 + l) * 512 + j)) * 512 + ch * 8;
            const f32x4 x0 = *(const f32x4*)src, x1 = *(const f32x4*)(src + 4);
            bf16_t* dst = (bf16_t*)(a.ws + (kv ? WS_VB : WS_KB) + (size_t)l * KV_LAYER) + (size_t)(NCTX + b * 2560 + 2048 + j) * 512 + ch * 8;
            *(u32x4*)dst = (u32x4){pk2(x0[0], x0[1]), pk2(x0[2], x0[3]), pk2(x1[0], x1[1]), pk2(x1[2], x1[3])}; }
    }
}

DI void phase_norm(const Args& a, const Ctx& c0_, int l, bool second) {
    Ctx c = c0_; c.tid = opaque_tid(); c.lane = c.tid & 63; c.wave = __builtin_amdgcn_readfirstlane(c.tid >> 6);
    const int gw = c.vcu * 8 + c.wave, NGW = c.G * 8;
    const float* g = a.in[second ? 24 : 8] + l * D;
    const float* modl = (const float*)(a.ws + WS_MOD) + (size_t)l * 5 * 12288;
    const int sh = second ? 3 : 0, sc = second ? 4 : 1;
    bf16_t* H = (bf16_t*)(a.ws + WS_H);
    const bool from_in = (l == 0 && !second);
    for (int row = gw; row < MT; row += NGW) {
        const float* xr = from_in ? (row < NCTX ? a.in[0] + (size_t)row * D : a.in[1] + (size_t)(row - NCTX) * D) : a.out + (size_t)row * D;
        f32x4 v[8]; float ss = 0.f;
#pragma unroll
        for (int j = 0; j < 8; ++j) { v[j] = *(const f32x4*)(xr + 4 * c.lane + 256 * j); const f32x4 q = v[j] * v[j]; ss += (q[0] + q[1]) + (q[2] + q[3]); }
        const float rn = 1.0f / sqrtf(wave_sum(ss) * (1.f / D) + EPS);
        const float* mv = modl + (size_t)mod_vec(row) * 12288;
#pragma unroll
        for (int j = 0; j < 8; ++j) { const int col = 4 * c.lane + 256 * j;
            const f32x4 gg = *(const f32x4*)(g + col), s1 = *(const f32x4*)(mv + sc * 2048 + col), s0 = *(const f32x4*)(mv + sh * 2048 + col);
            const f32x4 o = v[j] * rn * gg * (s1 + 1.0f) + s0;
            u32x2 w; w.x = pk2(o[0], o[1]); w.y = pk2(o[2], o[3]); *(u32x2*)(H + (size_t)row * D + col) = w; }
    }
}

DI void phase_pool(const Args& a, const Ctx& c0_) {
    Ctx c = c0_; c.tid = opaque_tid(); c.lane = c.tid & 63; c.wave = __builtin_amdgcn_readfirstlane(c.tid >> 6);
    const bf16_t* UP = (const bf16_t*)(a.ws + WS_UP); bf16_t* PP = (bf16_t*)(a.ws + WS_PP);
    const int gt = c.vcu * 512 + c.tid, NT = c.G * 512;
    for (int it = gt; it < MT * 64; it += NT) {
        const int row = it >> 6, ch = it & 63, w2 = 1 << (ch >> 4);
        int s0, L, t; if (row < NCTX) { s0 = row & ~255; L = 256; t = row & 255; } else { s0 = NCTX + ((row - NCTX) & ~2047); L = 2048; t = (row - NCTX) & 2047; }
        const int lo = max(t - w2, 0), hi = min(t + w2 - 1, L - 1);
        float acc[8];
#pragma unroll
        for (int e = 0; e < 8; ++e) acc[e] = 0.f;
        for (int j = lo; j <= hi; ++j) { const u32x4 x = *(const u32x4*)(UP + (size_t)(s0 + j) * 512 + ch * 8);
            acc[0] += bflo(x.x); acc[1] += bfhi(x.x); acc[2] += bflo(x.y); acc[3] += bfhi(x.y); acc[4] += bflo(x.z); acc[5] += bfhi(x.z); acc[6] += bflo(x.w); acc[7] += bfhi(x.w); }
        const u32x4 x = *(const u32x4*)(UP + (size_t)row * 512 + ch * 8);
        const float ic = 1.0f / (float)(hi - lo + 1);
        u32x4 o; o.x = pk2(acc[0] * ic - bflo(x.x), acc[1] * ic - bfhi(x.x)); o.y = pk2(acc[2] * ic - bflo(x.y), acc[3] * ic - bfhi(x.y));
        o.z = pk2(acc[4] * ic - bflo(x.z), acc[5] * ic - bfhi(x.z)); o.w = pk2(acc[6] * ic - bflo(x.w), acc[7] * ic - bfhi(x.w));
        *(u32x4*)(PP + (size_t)row * 512 + ch * 8) = o;
    }
}

DI void phase_conv(const Args& a, const Ctx& c0_, int l) {
    Ctx c = c0_; c.tid = opaque_tid(); c.lane = c.tid & 63; c.wave = __builtin_amdgcn_readfirstlane(c.tid >> 6);
    if (c.vcu >= 384) return;
    LAS float* Wl = (LAS float*)c.lds;
    LAS unsigned char* Gl = c.lds + 63488;
    const bf16_t* UC = (const bf16_t*)(a.ws + WS_UC); bf16_t* CS = (bf16_t*)(a.ws + WS_CS);
    const float* dw = a.in[16] + (size_t)l * 31 * 512;
    __syncthreads();
    for (int i = c.tid; i < 31 * 512 / 4; i += 512) *(LAS f32x4*)(Wl + 4 * i) = *(const f32x4*)(dw + 4 * i);
    f32x4 dwb[2], lng[2], lnb[2];
#pragma unroll
    for (int h = 0; h < 2; ++h) { dwb[h] = *(const f32x4*)(a.in[17] + l * 512 + 8 * c.lane + 4 * h); lng[h] = *(const f32x4*)(a.in[18] + l * 512 + 8 * c.lane + 4 * h); lnb[h] = *(const f32x4*)(a.in[19] + l * 512 + 8 * c.lane + 4 * h); }
    for (int unit = c.vcu; unit < 384; unit += c.G) {
        const int t0 = unit * 32;
        int s0, L; if (t0 < NCTX) { s0 = t0 & ~255; L = 256; } else { s0 = NCTX + ((t0 - NCTX) & ~2047); L = 2048; }
        __syncthreads();
        for (int it = c.tid; it < 62 * 64; it += 512) { const int rr = it >> 6, ch = it & 63, row = t0 - 15 + rr;
            u32x4 o = (u32x4){0u, 0u, 0u, 0u};
            if (row >= s0 && row < s0 + L) { const u32x4 xa = *(const u32x4*)(UC + (size_t)row * 1024 + ch * 8), xb = *(const u32x4*)(UC + (size_t)row * 1024 + 512 + ch * 8);
                o.x = pk2(bflo(xa.x) * sigmoid_fast(bflo(xb.x)), bfhi(xa.x) * sigmoid_fast(bfhi(xb.x))); o.y = pk2(bflo(xa.y) * sigmoid_fast(bflo(xb.y)), bfhi(xa.y) * sigmoid_fast(bfhi(xb.y)));
                o.z = pk2(bflo(xa.z) * sigmoid_fast(bflo(xb.z)), bfhi(xa.z) * sigmoid_fast(bfhi(xb.z))); o.w = pk2(bflo(xa.w) * sigmoid_fast(bflo(xb.w)), bfhi(xa.w) * sigmoid_fast(bfhi(xb.w))); }
            *(LAS u32x4*)(Gl + rr * 1024 + ch * 16) = o; }
        __syncthreads();
        f32x4 acc[4][2];
#pragma unroll
        for (int i = 0; i < 4; ++i) { acc[i][0] = dwb[0]; acc[i][1] = dwb[1]; }
        f32x4 R[4][2];
        const LAS unsigned char* gp = Gl + (4 * c.wave) * 1024 + c.lane * 16;
#define CONV_LD(XX_) do { const u32x4 q_ = *(const LAS u32x4*)(gp + (XX_) * 1024); R[(XX_) & 3][0] = (f32x4){bflo(q_.x), bfhi(q_.x), bflo(q_.y), bfhi(q_.y)}; R[(XX_) & 3][1] = (f32x4){bflo(q_.z), bfhi(q_.z), bflo(q_.w), bfhi(q_.w)}; } while (0)
        CONV_LD(0); CONV_LD(1); CONV_LD(2);
#pragma unroll
        for (int j = 0; j < 31; ++j) {
            CONV_LD(j + 3);
            const f32x4 w0 = *(const LAS f32x4*)(Wl + j * 512 + 8 * c.lane), w1 = *(const LAS f32x4*)(Wl + j * 512 + 8 * c.lane + 4);
#pragma unroll
            for (int i = 0; i < 4; ++i) { acc[i][0] += w0 * R[(j + i) & 3][0]; acc[i][1] += w1 * R[(j + i) & 3][1]; }
        }
#undef CONV_LD
#pragma unroll
        for (int i = 0; i < 4; ++i) {
            const f32x4 y0 = acc[i][0], y1 = acc[i][1];
            const float mu = wave_sum((y0[0] + y0[1]) + (y0[2] + y0[3]) + (y1[0] + y1[1]) + (y1[2] + y1[3])) * (1.f / 512.f);
            const f32x4 d0 = y0 - mu, d1 = y1 - mu; const f32x4 q0 = d0 * d0, q1 = d1 * d1;
            const float var = wave_sum((q0[0] + q0[1]) + (q0[2] + q0[3]) + (q1[0] + q1[1]) + (q1[2] + q1[3])) * (1.f / 512.f);
            const float rs = 1.0f / sqrtf(var + EPS);
            const f32x4 o0 = d0 * rs * lng[0] + lnb[0], o1 = d1 * rs * lng[1] + lnb[1];
            u32x4 w; w.x = pk2(silu_fast(o0[0]), silu_fast(o0[1])); w.y = pk2(silu_fast(o0[2]), silu_fast(o0[3])); w.z = pk2(silu_fast(o1[0]), silu_fast(o1[1])); w.w = pk2(silu_fast(o1[2]), silu_fast(o1[3]));
            *(u32x4*)(CS + (size_t)(t0 + 4 * c.wave + i) * 512 + 8 * c.lane) = w;
        }
    }
    __syncthreads();
}
namespace att {
constexpr int KROW = 272, VROW = 320, KBYTES = 64 * KROW, VBYTES = 64 * VROW, STG = KBYTES + VBYTES;
typedef short v4i16_t __attribute__((ext_vector_type(4)));
DI s16x4 vtr(const LAS unsigned char* p) { return __builtin_bit_cast(s16x4, __builtin_amdgcn_ds_read_tr16_b64_v4i16((LAS v4i16_t*)p)); }

DI void attn_unit(LAS unsigned char* lds, const bf16_t* Qh, const bf16_t* Kh, const bf16_t* Vh, int nt, float lam, const float* gsub, float post, bf16_t* out) {
    const int tid = opaque_tid(), lane = tid & 63, w = __builtin_amdgcn_readfirstlane(tid >> 6), mp = w >> 2, qs = w & 3, r = lane & 31, hh = lane >> 5;
    bf16x8 qf[4];
    { const bf16_t* qp = Qh + (size_t)(qs * 32 + r) * 512 + mp * 64 + hh * 8;
#pragma unroll
      for (int ks = 0; ks < 4; ++ks) qf[ks] = *(const bf16x8*)(qp + ks * 16); }
    const int srow = tid >> 4, sch = tid & 15;
    const char* kg = (const char*)Kh + (size_t)srow * 1024 + sch * 16;
    const char* vg = (const char*)Vh + (size_t)srow * 1024 + sch * 16;
    const int kdst = srow * KROW + sch * 16, vdst = KBYTES + srow * VROW + sch * 16;
    u32x4 sk0, sk1, sv0, sv1;
#define ATT_LOAD(t) do { const size_t o_ = (size_t)(t) * 65536; sk0 = *(const u32x4*)(kg + o_); sk1 = *(const u32x4*)(kg + o_ + 32768); sv0 = *(const u32x4*)(vg + o_); sv1 = *(const u32x4*)(vg + o_ + 32768); } while (0)
#define ATT_WRITE(buf) do { LAS unsigned char* b_ = lds + (buf) * STG; *(LAS u32x4*)(b_ + kdst) = sk0; *(LAS u32x4*)(b_ + kdst + 32 * KROW) = sk1; *(LAS u32x4*)(b_ + vdst) = sv0; *(LAS u32x4*)(b_ + vdst + 32 * VROW) = sv1; } while (0)
    ATT_LOAD(0); ATT_WRITE(0);
    __syncthreads();
    f32x16 o[4];
#pragma unroll
    for (int d = 0; d < 4; ++d)
#pragma unroll
        for (int i = 0; i < 16; ++i) o[d][i] = 0.f;
    float mrun = -INFINITY, lrun = 0.f;
    const int koff = r * KROW + (mp * 64 + hh * 8) * 2;
    const int voff = KBYTES + (((lane & 15) >> 2) + 4 * hh) * VROW + (((lane >> 4) & 1) * 16 + (lane & 3) * 4) * 2;
    for (int t = 0; t < nt; ++t) {
        const LAS unsigned char* base = lds + (t & 1) * STG;
        if (t + 1 < nt) ATT_LOAD(t + 1);
        f32x16 p0, p1;
#pragma unroll
        for (int i = 0; i < 16; ++i) { p0[i] = 0.f; p1[i] = 0.f; }
#pragma unroll
        for (int ks = 0; ks < 4; ++ks) {
            const bf16x8 a0 = *(const LAS bf16x8*)(base + koff + ks * 32), a1 = *(const LAS bf16x8*)(base + koff + 32 * KROW + ks * 32);
            p0 = __builtin_amdgcn_mfma_f32_32x32x16_bf16(a0, qf[ks], p0, 0, 0, 0);
            p1 = __builtin_amdgcn_mfma_f32_32x32x16_bf16(a1, qf[ks], p1, 0, 0, 0);
        }
        float mx = fmaxf(p0[0], p1[0]);
#pragma unroll
        for (int i = 1; i < 16; ++i) mx = fmaxf(mx, fmaxf(p0[i], p1[i]));
        mx = fmaxf(mx, __shfl_xor(mx, 32));
        const float mnew = fmaxf(mrun, mx), alpha = fast_exp2(mrun - mnew);
        mrun = mnew;
        float ls = 0.f;
#pragma unroll
        for (int i = 0; i < 16; ++i) { p0[i] = fast_exp2(p0[i] - mnew); p1[i] = fast_exp2(p1[i] - mnew); ls += p0[i] + p1[i]; }
        lrun = lrun * alpha + ls;
#pragma unroll
        for (int d = 0; d < 4; ++d)
#pragma unroll
            for (int i = 0; i < 16; ++i) o[d][i] *= alpha;
        bf16x8 pf[4];
#pragma unroll
        for (int s = 0; s < 4; ++s) {
            u32x4 wv;
            if (s < 2) { wv.x = pk2(p0[8 * s + 0], p0[8 * s + 1]); wv.y = pk2(p0[8 * s + 2], p0[8 * s + 3]); wv.z = pk2(p0[8 * s + 4], p0[8 * s + 5]); wv.w = pk2(p0[8 * s + 6], p0[8 * s + 7]); }
            else { const int q = 8 * (s - 2); wv.x = pk2(p1[q + 0], p1[q + 1]); wv.y = pk2(p1[q + 2], p1[q + 3]); wv.z = pk2(p1[q + 4], p1[q + 5]); wv.w = pk2(p1[q + 6], p1[q + 7]); }
            pf[s] = __builtin_bit_cast(bf16x8, wv);
        }
#pragma unroll
        for (int d = 0; d < 4; ++d)
#pragma unroll
            for (int s = 0; s < 4; ++s) {
                const s16x4 lo = vtr(base + voff + (16 * s) * VROW + d * 64), hi = vtr(base + voff + (16 * s + 8) * VROW + d * 64);
                const bf16x8 vf = (bf16x8){lo[0], lo[1], lo[2], lo[3], hi[0], hi[1], hi[2], hi[3]};
                o[d] = __builtin_amdgcn_mfma_f32_32x32x16_bf16(vf, pf[s], o[d], 0, 0, 0);
            }
        if (t + 1 < nt) ATT_WRITE((t + 1) & 1);
        __syncthreads();
    }
#undef ATT_LOAD
#undef ATT_WRITE
    const float inv = 1.0f / (lrun + __shfl_xor(lrun, 32));
    LAS f32x4* X = (LAS f32x4*)lds;
    if (mp == 1) {
        const float f = inv * lam;
#pragma unroll
        for (int d = 0; d < 4; ++d)
#pragma unroll
            for (int i = 0; i < 4; ++i) X[((qs * 16 + d * 4 + i) * 64) + lane] = (f32x4){o[d][4 * i] * f, o[d][4 * i + 1] * f, o[d][4 * i + 2] * f, o[d][4 * i + 3] * f};
    }
    __syncthreads();
    if (mp == 0) {
        float ss = 0.f;
#pragma unroll
        for (int d = 0; d < 4; ++d)
#pragma unroll
            for (int i = 0; i < 4; ++i) { const f32x4 x = X[((qs * 16 + d * 4 + i) * 64) + lane];
#pragma unroll
                for (int e = 0; e < 4; ++e) { const float v = o[d][4 * i + e] * inv - x[e]; o[d][4 * i + e] = v; ss += v * v; } }
        ss += __shfl_xor(ss, 32);
        const float rn = post / sqrtf(ss * (1.f / 128.f) + EPS);
        bf16_t* op = out + (size_t)(qs * 32 + r) * D;
#pragma unroll
        for (int d = 0; d < 4; ++d)
#pragma unroll
            for (int i = 0; i < 4; ++i) { const int dd = d * 32 + 8 * i + 4 * hh; const f32x4 g = *(const f32x4*)(gsub + dd);
                u32x2 wv; wv.x = pk2(o[d][4 * i] * rn * g[0], o[d][4 * i + 1] * rn * g[1]); wv.y = pk2(o[d][4 * i + 2] * rn * g[2], o[d][4 * i + 3] * rn * g[3]);
                *(u32x2*)(op + dd) = wv; }
    }
    __syncthreads();
}

DI void attn_phase(const Args& a, const Ctx& c, int l) {
    const bf16_t* QB = (const bf16_t*)(a.ws + WS_QB);
    const bf16_t* KB = (const bf16_t*)(a.ws + WS_KB + (size_t)l * KV_LAYER);
    const bf16_t* VB = (const bf16_t*)(a.ws + WS_VB + (size_t)l * KV_LAYER);
    bf16_t* YM = (bf16_t*)(a.ws + WS_YMIX);
    const float* misc = (const float*)(a.ws + WS_MISC);
    const float lam = misc[l], post = 1.0f - (0.8f - 0.6f * expf(-0.3f * (float)l));
    const float* gsub = a.in[15] + l * 128;
    for (int u = c.vcu; u < 384; u += c.G) {
        if (u < 256) { const int b = u >> 6, h = (u >> 4) & 3, qb = u & 15; const size_t row0 = (size_t)NCTX + (size_t)b * 2048 + qb * 128, k0 = (size_t)NCTX + (size_t)b * 2560;
            attn_unit(c.lds, QB + row0 * 512 + h * 128, KB + k0 * 512 + h * 128, VB + k0 * 512 + h * 128, 40, lam, gsub, post, YM + row0 * D + 512 + h * 128); }
        else { const int v = u - 256, b = v >> 3, h = (v >> 1) & 3, qb = v & 1; const size_t row0 = (size_t)b * 256 + qb * 128, k0 = (size_t)b * 256;
            attn_unit(c.lds, QB + row0 * 512 + h * 128, KB + k0 * 512 + h * 128, VB + k0 * 512 + h * 128, 4, lam, gsub, post, YM + row0 * D + 512 + h * 128); }
    }
}
}
namespace pg8 {
struct GenOrder {
    int kind, G, c, nM, nN, nS; const char* A; const char* B; size_t tA, tB, sB; long crow0, cseq, ldc;
    DI bool next(int i, Unit& u) const {
        const long L = (long)i * G + c;
        if (kind == 0) {
            const int nwg = nM * nN; if (L >= nwg) return false;
            int wgid = (int)L; { const int q = nwg / NXCD, r = nwg % NXCD, xcd = wgid % NXCD, off = wgid / NXCD; wgid = (xcd < r ? xcd * (q + 1) : r * (q + 1) + (xcd - r) * q) + off; }
            const int nig = WGM * nN, gid = wgid / nig, fm = gid * WGM, gsz = (nM - fm) < WGM ? (nM - fm) : WGM;
            u.pm = fm + ((wgid % nig) % gsz); u.pn = (wgid % nig) / gsz;
            u.a = A + (size_t)u.pm * tA; u.b = B + (size_t)u.pn * tB; u.coff = (long)u.pm * BM * ldc + (long)u.pn * BM; u.ld1 = (int)ldc; u.ld2 = 128 * ldc;
        } else if (kind == 1) {
            if (L >= (long)nS * nM * nN) return false;
            const int s = (int)L / (nM * nN), rem = (int)L % (nM * nN); u.pm = rem / nN; u.pn = rem % nN;
            u.a = A + (size_t)u.pm * tA; u.b = B + (size_t)s * sB + (size_t)u.pn * tB; u.coff = (crow0 + (long)s * cseq + (long)u.pm * BM) * ldc + (long)u.pn * BM; u.ld1 = (int)ldc; u.ld2 = 128 * ldc;
        } else {
            if (L >= 192) return false;
            const int hd = (int)L / 48, pt = (int)L % 48; u.pm = 0; u.pn = 0;
            long base, l0; int Ls;
            if (pt < 16) { Ls = 256; base = (long)pt * (512 * 2 * 256); l0 = 0; } else { const int s = (pt - 16) >> 3; Ls = 2048; base = (long)16 * 512 * 512 + (long)s * (512 * 2 * 2048); l0 = ((pt - 16) & 7) * 256; }
            u.a = A; u.b = B + ((size_t)pt * 256 * 512 + hd * 128) * 2; u.coff = base + (long)(hd * 128) * 2 * Ls + l0; u.ld1 = 2 * Ls; u.ld2 = Ls;
        }
        u.pm = uni(u.pm); u.pn = uni(u.pn); u.a = uni_p(u.a); u.b = uni_p(u.b); u.coff = uni_l(u.coff); u.ld1 = uni(u.ld1); u.ld2 = uni_l(u.ld2); return true;
    }
};
}

DI void store_jobs(const Args& a, const Ctx& c, int l, int jlo, int jhi) {
    unsigned char* wl = a.ws + WS_W + (size_t)l * W_LAYER;
    const int bid = (int)blockIdx.x, G = c.G;
    for (int job = jlo; job < jhi; ++job) {
        pg8::Gemm g; pg8::GenOrder S; pg8::EpiStore E;
        S.G = G; S.nS = 1; S.sB = 0; S.crow0 = 0; S.cseq = 0; E.cscale = nullptr; E.cbias = nullptr; E.alpha = 1.f;
        if (job == 0) { g = pg8::Gemm{128, 512, 128}; S.kind = 2; S.c = bid; S.nM = 1; S.nN = 1; S.A = (const char*)(a.ws + WS_DC); S.B = (const char*)(a.ws + WS_UF); S.tA = 0; S.tB = 0; S.ldc = 0;
            E.dst = (bf16_t*)(a.ws + WS_TT); }
        else if (job == 1) { g = pg8::Gemm{4096, 4096, 4096}; S.kind = 1; S.c = bid; S.nS = 4; S.nM = 8; S.nN = 2; S.A = (const char*)(a.ws + WS_DL2); S.tA = (size_t)256 * 4096 * 2;
            S.B = (const char*)(a.ws + WS_TT) + (size_t)16 * 512 * 512 * 2; S.sB = (size_t)512 * 4096 * 2; S.tB = (size_t)256 * 4096 * 2; S.crow0 = NCTX; S.cseq = 2048; S.ldc = 512;
            E.dst = (bf16_t*)(a.ws + WS_FF); E.alpha = 1.0f / 512.0f; }
        else if (job == 4) { g = pg8::Gemm{512, 512, 512}; S.kind = 1; S.c = (bid - 64 + G) % G; S.nS = 16; S.nM = 1; S.nN = 2; S.A = (const char*)(a.ws + WS_DL1); S.tA = 0;
            S.B = (const char*)(a.ws + WS_TT); S.sB = (size_t)512 * 512 * 2; S.tB = (size_t)256 * 512 * 2; S.crow0 = 0; S.cseq = 256; S.ldc = 512;
            E.dst = (bf16_t*)(a.ws + WS_FF); E.alpha = 0.0055242717280199f; }
        else { g = pg8::Gemm{512, 512, 512}; S.kind = 0; S.nM = MT / 256; S.nN = 2; S.tA = (size_t)256 * 512 * 2; S.tB = (size_t)256 * 512 * 2; S.ldc = D;
            if (job == 2) { S.c = (bid - 64 + G) % G; S.A = (const char*)(a.ws + WS_PP); S.B = (const char*)(wl + W_PL); E.dst = (bf16_t*)(a.ws + WS_YMIX); E.cscale = a.in[11] + l * 512; }
            else if (job == 3) { S.c = (bid - 160 + G) % G; S.A = (const char*)(a.ws + WS_CS); S.B = (const char*)(wl + W_CP); E.dst = (bf16_t*)(a.ws + WS_YMIX) + 1024; E.cbias = a.in[21] + l * 512; }
            else { S.c = bid; S.A = (const char*)(a.ws + WS_FF); S.B = (const char*)(wl + W_FW); E.dst = (bf16_t*)(a.ws + WS_YMIX) + 1536; } }
#ifndef NO_STORE
        (void)g;
        if (job == 0) pg8::gemm_phase<pg8::EpiStore, pg8::GenOrder, true>(c.lds, pg8::Gemm{128, 512, 128}, S, E);
        else if (job == 1) pg8::gemm_phase<pg8::EpiStore, pg8::GenOrder, true>(c.lds, pg8::Gemm{4096, 4096, 4096}, S, E);
        else pg8::gemm_phase<pg8::EpiStore, pg8::GenOrder, true>(c.lds, pg8::Gemm{512, 512, 512}, S, E);
#endif
    }
}

#define IN(k) (lo <= (k) && (k) < hi)
#define SEAM(k) do { if (IN(k) && IN((k) + 1)) xcd_barrier(bar); } while (0)
template <int l> DI void run_layer(const Args& a, const Ctx& c, const XcdBarrier& bar, int lo, int hi, int bid) {
        constexpr int pb = 1 + 9 * l;
        unsigned char* wl = a.ws + WS_W + (size_t)l * W_LAYER;
        const float* modl = (const float*)(a.ws + WS_MOD) + (size_t)l * 5 * 12288;
        if (IN(pb + 0)) {
#ifndef NO_NORM
            phase_norm(a, c, l, false);
#endif
        }
        SEAM(pb + 0);
        if (IN(pb + 1)) {
            pg8::Gemm g{D, D, D}; pg8::StaticOrder S; S.init(MT, INC, c.G, bid, a.ws + WS_H, D, wl + W_IN, D, 0);
            const float* misc = (const float*)(a.ws + WS_MISC);
            pg8::EpiG1 E{(bf16_t*)(a.ws + WS_UP), (bf16_t*)(a.ws + WS_QB), (bf16_t*)(a.ws + WS_KB + (size_t)l * KV_LAYER), (bf16_t*)(a.ws + WS_VB + (size_t)l * KV_LAYER),
                         (bf16_t*)(a.ws + WS_UC), (bf16_t*)(a.ws + WS_UF), a.out + (size_t)MT * D, a.out + (size_t)MT * D + (size_t)16 * 2 * 256 * 512,
                         a.in[12] + l * 64, a.in[13] + l * 64, misc + 64, misc + 64 + 1024, l};
#ifndef NO_G1
            pg8::gemm_phase<pg8::EpiG1, pg8::StaticOrder, true>(c.lds, g, S, E);
#endif
        }
        SEAM(pb + 1);
        if (IN(pb + 2)) {
#ifndef NO_ATT
            att::attn_phase(a, c, l);
#endif
#ifndef NO_POOL
            phase_pool(a, c);
#endif
#ifndef NO_CONV
            phase_conv(a, c, l);
#endif
            store_jobs(a, c, l, 0, 1);
        }
        SEAM(pb + 2);
        if (IN(pb + 3)) store_jobs(a, c, l, 1, 5);
        SEAM(pb + 3);
        if (IN(pb + 4)) store_jobs(a, c, l, 5, 6);
        SEAM(pb + 4);
        if (IN(pb + 5)) {
            pg8::Gemm g{D, D, D}; pg8::StaticOrder S; S.init(MT, D, c.G, bid, a.ws + WS_YMIX, D, wl + W_OUT, D, D);
            pg8::EpiResid E{l == 0 ? a.in[0] : a.out, l == 0 ? a.in[1] : a.out + (size_t)NCTX * D, a.out, modl + 2 * 2048};
#ifndef NO_RESID
            pg8::gemm_phase<pg8::EpiResid, pg8::StaticOrder, true>(c.lds, g, S, E);
#endif
        }
        SEAM(pb + 5);
        if (IN(pb + 6)) {
#ifndef NO_NORM
            phase_norm(a, c, l, true);
#endif
        }
        SEAM(pb + 6);
        if (IN(pb + 7)) {
            pg8::Gemm g{D, D, D}; pg8::StaticOrder S; S.init(MT, 2 * DFF, c.G, bid, a.ws + WS_H, D, wl + W_GU, D, 0);
            pg8::EpiSwiglu E{(bf16_t*)(a.ws + WS_GU)};
#ifndef NO_SWIGLU
            pg8::gemm_phase<pg8::EpiSwiglu, pg8::StaticOrder, true>(c.lds, g, S, E);
#endif
        }
        SEAM(pb + 7);
        if (IN(pb + 8)) {
            pg8::Gemm g{DFF, DFF, DFF}; pg8::StaticOrder S; S.init(MT, D, c.G, bid, a.ws + WS_GU, DFF, wl + W_DN, DFF, D);
            pg8::EpiResid E{a.out, a.out + (size_t)NCTX * D, a.out, modl + 5 * 2048};
#ifndef NO_RESID
            pg8::gemm_phase<pg8::EpiResid, pg8::StaticOrder, true>(c.lds, g, S, E);
#endif
        }
        if (l == 0) SEAM(pb + 8);
}
__global__ void __launch_bounds__(512, 2) mk_fwd(Args a) {
    extern __shared__ __attribute__((aligned(16))) unsigned char lds_raw[];
    Ctx c;
    c.lds = (LAS unsigned char*)lds_raw;
    c.tid = threadIdx.x; c.lane = c.tid & 63; c.wave = __builtin_amdgcn_readfirstlane(c.tid >> 6);
    c.G = gridDim.x; { const int bx = blockIdx.x; c.vcu = (c.G % 8 == 0) ? (bx % 8) * (c.G / 8) + bx / 8 : bx; }
    volatile LAS unsigned* MISC = (volatile LAS unsigned*)(c.lds + MISC_OFF);
    for (int u = c.tid; u < (LDS_BYTES - RING_BYTES) / 4; u += 512) ((LAS unsigned*)(c.lds + RING_BYTES))[u] = 0u;
    __syncthreads();
    XcdBarrier bar; bar.bar = (unsigned*)(a.ws + WS_CTL) + 4096; bar.x = 0; bar.st = nullptr;
    const bool multi = (a.ph_hi - a.ph_lo) > 1;
    if (multi) bar = xcd_barrier_post((unsigned*)(a.ws + WS_CTL) + 4096, MISC + 8);
    const int bid = (int)blockIdx.x;
    const int lo = a.ph_lo, hi = a.ph_hi;
#ifndef NO_P0
    if (IN(0)) phase_p0(a, c);
#endif
    SEAM(0);
    run_layer<0>(a, c, bar, lo, hi, bid);
    run_layer<1>(a, c, bar, lo, hi, bid);
#undef IN
#undef SEAM
}
constexpr int N_PHASES = 19;
#ifndef TEST_STAGE
#define TEST_STAGE 0
#endif

#if TEST_STAGE >= 1 && TEST_STAGE <= 3
namespace hy {
__global__ __launch_bounds__(256) void k_unpack(const bf16_t* src, int lds_, int keymode, float* dst, int ldd, int cols, float scale) {
    const int cpr = cols / 8; const size_t idx = (size_t)blockIdx.x * 256 + threadIdx.x; if (idx >= (size_t)MT * cpr) return;
    const int row = (int)(idx / cpr), ch = (int)(idx % cpr); const int srow = keymode ? key_row(row) : row;
    const u32x4 x = *(const u32x4*)(src + (size_t)srow * lds_ + ch * 8);
    float* d = dst + (size_t)row * ldd + ch * 8;
    d[0] = bflo(x.x) * scale; d[1] = bfhi(x.x) * scale; d[2] = bflo(x.y) * scale; d[3] = bfhi(x.y) * scale; d[4] = bflo(x.z) * scale; d[5] = bfhi(x.z) * scale; d[6] = bflo(x.w) * scale; d[7] = bfhi(x.w) * scale;
}
}
#endif

extern "C" void kernel_launch(void* const* d_in, const int* in_sizes, int n_in, void* d_out, int out_size, void* d_ws, size_t ws_size, hipStream_t stream) {
    static int grid = 0;
    if (grid == 0) {
        int dev = 0, cus = 0;
        if (hipGetDevice(&dev) != hipSuccess || hipDeviceGetAttribute(&cus, hipDeviceAttributeMultiprocessorCount, dev) != hipSuccess) { fprintf(stderr, "kernel_launch: device query failed\n"); grid = -1; return; }
        if (hipFuncSetAttribute((const void*)mk_fwd, hipFuncAttributeMaxDynamicSharedMemorySize, LDS_BYTES) != hipSuccess) { fprintf(stderr, "kernel_launch: hipFuncSetAttribute failed\n"); grid = -1; return; }
        (void)hipGetLastError();
        grid = cus;
        if (n_in != 28 || ws_size < WS_END) { fprintf(stderr, "kernel_launch: unexpected n_in %d / ws %zu\n", n_in, ws_size); }
    }
    if (grid < 0) return;
    (void)in_sizes; (void)out_size;
    (void)hipMemsetAsync((char*)d_ws + WS_CTL, 0, CTL_ZERO_BYTES, stream);
    Args a{};
    for (int i = 0; i < 28; ++i) a.in[i] = (const float*)d_in[i];
    a.out = (float*)d_out; a.ws = (unsigned char*)d_ws;
    auto run = [&](int lo, int hi, bool per_phase) {
        if (per_phase) { for (int p = lo; p < hi; ++p) { a.ph_lo = p; a.ph_hi = p + 1; hipLaunchKernelGGL(mk_fwd, dim3(grid), dim3(512), LDS_BYTES, stream, a); } }
        else { a.ph_lo = lo; a.ph_hi = hi; hipLaunchKernelGGL(mk_fwd, dim3(grid), dim3(512), LDS_BYTES, stream, a); }
    };
#if TEST_STAGE == 0
    run(0, N_PHASES, false);
#elif TEST_STAGE == 9
    run(0, N_PHASES, true);
#else
    using namespace nv;
    constexpr int mk_hi = TEST_STAGE == 1 ? 3 : (TEST_STAGE == 2 ? 6 : 10);
    run(0, mk_hi, true);
    const float* cache_k = (const float*)d_in[2]; const float* cache_v = (const float*)d_in[3];
    const float* cc = (const float*)d_in[4]; const float* c_ctx = (const float*)d_in[5];
    const float* w_ada = (const float*)d_in[6]; const float* b_ada = (const float*)d_in[7]; const float* g_norm1 = (const float*)d_in[8];
    const float* w_in = (const float*)d_in[9]; const float* pool_w = (const float*)d_in[10]; const float* pool_scale = (const float*)d_in[11];
    const float* g_q = (const float*)d_in[12]; const float* g_k = (const float*)d_in[13]; const float* lam = (const float*)d_in[14];
    const float* g_subln = (const float*)d_in[15]; const float* conv_dw = (const float*)d_in[16]; const float* conv_dw_b = (const float*)d_in[17];
    const float* conv_ln_g = (const float*)d_in[18]; const float* conv_ln_b = (const float*)d_in[19]; const float* conv_pw = (const float*)d_in[20];
    const float* conv_pw_b = (const float*)d_in[21]; const float* fourier_w = (const float*)d_in[22]; const float* w_out = (const float*)d_in[23];
    const float* g_norm2 = (const float*)d_in[24]; const float* w_gate = (const float*)d_in[25]; const float* w_up = (const float*)d_in[26];
    const float* w_down = (const float*)d_in[27];
    float* out = (float*)d_out; float* X = out; float* NCK = out + (size_t)MT * D; float* NCV = NCK + (size_t)16 * 2 * 256 * 512;
    unsigned char* wsb = (unsigned char*)d_ws;
    auto at = [&](size_t mib) { return (float*)(wsb + mib * MiB); };
    float* MOD = at(2); float* LAMV = MOD + 131072; float* CL1 = LAMV + 64; float* SL1 = CL1 + 65536; float* C128 = SL1 + 65536; float* S128 = C128 + 16384;
    float* Z = at(4); float* QN = at(172); float* KN = at(196); float* H = at(472); float* YMIX = at(568); float* T0 = at(664); float* T1 = at(688); float* T2 = at(712);
    float* CL2 = at(736); float* SL2 = at(752);
    const int blk512 = MT * 512 / 256;
#if TEST_STAGE == 1
    {
        using hy::k_unpack; const bf16_t* wsq = (const bf16_t*)wsb;
        k_unpack<<<MT * 64 / 256, 256, 0, stream>>>((const bf16_t*)(wsb + WS_UP), 512, 0, Z, INC, 512, 1.f);
        k_unpack<<<MT * 64 / 256, 256, 0, stream>>>((const bf16_t*)(wsb + WS_VB), 512, 1, Z + 1536, INC, 512, 1.f);
        k_unpack<<<MT * 128 / 256, 256, 0, stream>>>((const bf16_t*)(wsb + WS_UC), 1024, 0, Z + 2048, INC, 1024, 1.f);
        k_unpack<<<MT * 64 / 256, 256, 0, stream>>>((const bf16_t*)(wsb + WS_UF), 512, 0, Z + 3072, INC, 512, 1.f);
        k_unpack<<<MT * 64 / 256, 256, 0, stream>>>((const bf16_t*)(wsb + WS_QB), 512, 0, QN, 512, 512, 1.0f / QSCALE);
        k_unpack<<<MT * 64 / 256, 256, 0, stream>>>((const bf16_t*)(wsb + WS_KB), 512, 1, KN, 512, 512, 1.f);
        (void)wsq;
    }
#elif TEST_STAGE == 2
    hy::k_unpack<<<MT * 256 / 256, 256, 0, stream>>>((const bf16_t*)(wsb + WS_YMIX), D, 0, YMIX, D, D, 1.f);
#endif
    k_adaln<<<dim3(48, 2), 256, 0, stream>>>(cc, c_ctx, w_ada, b_ada, MOD);
    k_lam<<<2, 64, 0, stream>>>(lam, LAMV);
    k_dftmat<<<2048 * 2048 / 256, 256, 0, stream>>>(CL2, SL2, 2048);
    k_dftmat<<<256 * 256 / 256, 256, 0, stream>>>(CL1, SL1, 256);
    k_dftmat<<<128 * 128 / 256, 256, 0, stream>>>(C128, S128, 128);
    auto gemm = [&](const float* A, int lda, const float* B, int ldb, float* C, int ldc, int M, int N, int K, float alpha, float beta) {
        k_gemm<<<dim3(N / 128, M / 128), 256, 0, stream>>>(A, lda, B, ldb, C, ldc, K, alpha, beta);
    };
    constexpr int l_start = TEST_STAGE == 3 ? 1 : 0, s_start = TEST_STAGE == 1 ? 1 : (TEST_STAGE == 2 ? 2 : 0);
    for (int l = l_start; l < 2; ++l) {
        const int s0 = (l == l_start) ? s_start : 0;
        const float* modl = MOD + (size_t)l * 5 * 12288;
        const float lam_init = 0.8f - 0.6f * (float)exp(-0.3 * l);
        if (s0 <= 0) {
            k_norm_mod<<<MT, 256, 0, stream>>>(X, g_norm1 + l * D, modl, 0, 1, H);
            gemm(H, D, w_in + (size_t)l * D * INC, INC, Z, INC, MT, INC, D, 1.f, 0.f);
            k_qknorm<<<dim3(MT, 16), 64, 0, stream>>>(Z, g_q + l * 64, g_k + l * 64, QN, KN);
            for (int b = 0; b < 16; ++b) {
                (void)hipMemcpyAsync(NCK + ((size_t)(b * 2 + l) * 256) * 512, KN + (size_t)b * 256 * 512, (size_t)256 * 512 * 4, hipMemcpyDeviceToDevice, stream);
                k_copy_cols<<<256 * 512 / 256, 256, 0, stream>>>(Z + (size_t)b * 256 * INC, INC, 1536, NCV + ((size_t)(b * 2 + l) * 256) * 512, 512);
            }
        }
        if (s0 <= 1) {
            for (int b = 0; b < 16; ++b) { const size_t r0 = (size_t)b * 256;
                hipLaunchKernelGGL(k_attn, dim3(128, 4), dim3(256), 0, stream, QN + r0 * 512, 512, KN + r0 * 512, 512, Z + r0 * INC + 1536, INC, 256,
                                   (const float*)nullptr, (const float*)nullptr, 0, LAMV + l, g_subln + l * 128, 1.f - lam_init, YMIX + r0 * D + 512, D); }
            for (int b = 0; b < 4; ++b) { const size_t r0 = (size_t)NCTX + (size_t)b * 2048;
                hipLaunchKernelGGL(k_attn, dim3(1024, 4), dim3(256), 0, stream, QN + r0 * 512, 512, KN + r0 * 512, 512, Z + r0 * INC + 1536, INC, 2048,
                                   cache_k + ((size_t)(b * 2 + l) * 512) * 512, cache_v + ((size_t)(b * 2 + l) * 512) * 512, 512, LAMV + l, g_subln + l * 128, 1.f - lam_init, YMIX + r0 * D + 512, D); }
            k_pool<<<blk512, 256, 0, stream>>>(Z, T0);
            for (int g = 0; g < 4; ++g) gemm(T0 + g * 128, 512, pool_w + ((size_t)(l * 4 + g) * 128) * 128, 128, YMIX + g * 128, D, MT, 128, 128, 1.f, 0.f);
            k_scale_cols<<<blk512, 256, 0, stream>>>(YMIX, D, pool_scale + l * 512);
            k_glu<<<blk512, 256, 0, stream>>>(Z, T0);
            k_dwconv<<<blk512, 256, 0, stream>>>(T0, conv_dw + (size_t)l * 31 * 512, conv_dw_b + l * 512, T1);
            k_ln_silu<<<MT, 256, 0, stream>>>(T1, conv_ln_g + l * 512, conv_ln_b + l * 512, T0);
            gemm(T0, 512, conv_pw + (size_t)l * 512 * 512, 512, YMIX + 1024, D, MT, 512, 512, 1.f, 0.f);
            k_add_bias<<<blk512, 256, 0, stream>>>(YMIX + 1024, D, conv_pw_b + l * 512);
            for (int hd = 0; hd < 4; ++hd) {
                gemm(Z + 3072 + hd * 128, INC, C128, 128, T1 + hd * 128, 512, MT, 128, 128, 1.f, 0.f);
                gemm(Z + 3072 + hd * 128, INC, S128, 128, T2 + hd * 128, 512, MT, 128, 128, 1.f, 0.f);
            }
            for (int b = 0; b < 16; ++b) { const size_t r0 = (size_t)b * 256; const float s = 1.f / sqrtf(256.f * 128.f);
                gemm(CL1, 256, T1 + r0 * 512, 512, T0 + r0 * 512, 512, 256, 512, 256, s, 0.f);
                gemm(SL1, 256, T2 + r0 * 512, 512, T0 + r0 * 512, 512, 256, 512, 256, -s, 1.f); }
            for (int b = 0; b < 4; ++b) { const size_t r0 = (size_t)NCTX + (size_t)b * 2048; const float s = 1.f / sqrtf(2048.f * 128.f);
                gemm(CL2, 2048, T1 + r0 * 512, 512, T0 + r0 * 512, 512, 2048, 512, 2048, s, 0.f);
                gemm(SL2, 2048, T2 + r0 * 512, 512, T0 + r0 * 512, 512, 2048, 512, 2048, -s, 1.f); }
            gemm(T0, 512, fourier_w + (size_t)l * 512 * 512, 512, YMIX + 1536, D, MT, 512, 512, 1.f, 0.f);
        }
        if (s0 <= 2) {
            gemm(YMIX, D, w_out + (size_t)l * D * D, D, H, D, MT, D, D, 1.f, 0.f);
            if (l == 0 && TEST_STAGE != 3) {
                (void)hipMemcpyAsync(X, d_in[0], (size_t)NCTX * D * 4, hipMemcpyDeviceToDevice, stream);
                (void)hipMemcpyAsync(X + (size_t)NCTX * D, d_in[1], (size_t)NLAT * D * 4, hipMemcpyDeviceToDevice, stream);
            }
            k_resid<<<(size_t)MT * D / 256, 256, 0, stream>>>(X, H, modl, 2, 0);
        }
        {
            k_norm_mod<<<MT, 256, 0, stream>>>(X, g_norm2 + l * D, modl, 3, 4, H);
            for (int ch = 0; ch < MT / 2048; ++ch) {
                const size_t r0 = (size_t)ch * 2048;
                float* Gt = Z; float* U = Z + (size_t)2048 * DFF; float* Ff = T0;
                gemm(H + r0 * D, D, w_gate + (size_t)l * D * DFF, DFF, Gt, DFF, 2048, DFF, D, 1.f, 0.f);
                gemm(H + r0 * D, D, w_up + (size_t)l * D * DFF, DFF, U, DFF, 2048, DFF, D, 1.f, 0.f);
                k_swiglu<<<(size_t)2048 * DFF / 256, 256, 0, stream>>>(Gt, U);
                gemm(Gt, DFF, w_down + (size_t)l * DFF * D, D, Ff, D, 2048, D, DFF, 1.f, 0.f);
                k_resid<<<(size_t)2048 * D / 256, 256, 0, stream>>>(X, Ff, modl, 5, (int)r0);
            }
        }
    }
#endif
}
```
